# Optimizing an MI355X kernel written in HIP

```python
import math
import jax, jax.numpy as jnp
from jax import lax
import numpy as np

D_MODEL = 1024
BATCH = 4
SEQ = 4096
DEPTH = 2

ATTN_HEADS = 8
HEAD_DIM = 64
ATTN_WIDTH = ATTN_HEADS * HEAD_DIM
CONV_GROUPS = 8
CONV_WIDTH = D_MODEL - ATTN_WIDTH
CONV_KERNEL = 31
MIX_IN = 3 * ATTN_WIDTH + 2 * CONV_WIDTH
ROPE_THETA = 10000.0
MOBA_BLOCK = 256
MOBA_TOPK = 3
MOBA_Q_CHUNK = 32
PEER_HEADS = 8
PEER_NKEYS = 128
PEER_EXPERTS = PEER_NKEYS * PEER_NKEYS
PEER_QDIM = 256
PEER_HALF = PEER_QDIM // 2
PEER_TOPK = 16
PEER_TOK_CHUNK = 128
DEEPNORM_ALPHA = (2 * DEPTH) ** 0.25
DEEPNORM_BETA = (8 * DEPTH) ** -0.25
LN_EPS = 1e-5

kernel_name = "hymba_moba_conformer_peer_deepnorm"


def layer_norm(x, g, b):
    xf = x.astype(jnp.float32)
    mu = jnp.mean(xf, axis=-1, keepdims=True)
    xc = xf - mu
    var = jnp.mean(xc * xc, axis=-1, keepdims=True)
    y = xc * lax.rsqrt(var + LN_EPS) * g.astype(jnp.float32) + b.astype(jnp.float32)
    return y.astype(x.dtype)


def rope_tables(S):
    pos = jnp.arange(S, dtype=jnp.float32)
    inv = jnp.power(ROPE_THETA, -jnp.arange(0, HEAD_DIM, 2, dtype=jnp.float32) / HEAD_DIM)
    ang = pos[:, None] * inv[None, :]
    return jnp.cos(ang), jnp.sin(ang)


def apply_rope(t, cos, sin):
    tf = t.astype(jnp.float32)
    half = HEAD_DIM // 2
    t1, t2 = tf[..., :half], tf[..., half:]
    out = jnp.concatenate([t1 * cos - t2 * sin, t2 * cos + t1 * sin], axis=-1)
    return out.astype(t.dtype)


def split_heads(t, B, S):
    return t.reshape(B, S, ATTN_HEADS, HEAD_DIM).transpose(0, 2, 1, 3)


def moba_attention(q, k, v):
    B, H, S, Dh = q.shape
    nb = -(-S // MOBA_BLOCK)
    sp = nb * MOBA_BLOCK
    pad = ((0, 0), (0, 0), (0, sp - S), (0, 0))
    kb = jnp.pad(k, pad).reshape(B, H, nb, MOBA_BLOCK, Dh)
    vb = jnp.pad(v, pad).reshape(B, H, nb, MOBA_BLOCK, Dh)
    k_mean = jnp.mean(kb.astype(jnp.float32), axis=3)
    gate = jnp.einsum('bhsd,bhnd->bhsn', q.astype(jnp.float32), k_mean)
    q_blk = jnp.arange(S) // MOBA_BLOCK
    fully_past = jnp.arange(nb)[None, :] < q_blk[:, None]
    gate = jnp.where(fully_past, gate, -jnp.inf)
    n_sel = max(1, min(MOBA_TOPK, nb - 1))
    sel_score, sel_idx = lax.top_k(gate, n_sel)
    sel_valid = jnp.isfinite(sel_score)

    nc = S // MOBA_Q_CHUNK
    scale = HEAD_DIM ** -0.5
    b_ix = jnp.arange(B)[:, None, None, None]
    h_ix = jnp.arange(H)[None, :, None, None]

    def to_chunks(a):
        a = a.reshape(B, H, nc, MOBA_Q_CHUNK, *a.shape[3:])
        return jnp.moveaxis(a, 2, 0)

    def chunk_fn(args):
        q_c, idx_c, valid_c, start = args
        k_sel = kb[b_ix, h_ix, idx_c]
        v_sel = vb[b_ix, h_ix, idx_c]
        own = start // MOBA_BLOCK
        k_own = lax.dynamic_index_in_dim(kb, own, axis=2, keepdims=False)
        v_own = lax.dynamic_index_in_dim(vb, own, axis=2, keepdims=False)
        s_sel = jnp.einsum('bhqd,bhqrpd->bhqrp', q_c, k_sel,
                           preferred_element_type=jnp.float32) * scale
        s_sel = jnp.where(valid_c[..., None], s_sel, -jnp.inf)
        s_sel = s_sel.reshape(B, H, MOBA_Q_CHUNK, n_sel * MOBA_BLOCK)
        q_pos = start + jnp.arange(MOBA_Q_CHUNK)
        k_pos = own * MOBA_BLOCK + jnp.arange(MOBA_BLOCK)
        s_own = jnp.einsum('bhqd,bhpd->bhqp', q_c, k_own,
                           preferred_element_type=jnp.float32) * scale
        s_own = jnp.where(k_pos[None, :] <= q_pos[:, None], s_own, -jnp.inf)
        p = jax.nn.softmax(jnp.concatenate([s_sel, s_own], axis=-1), axis=-1).astype(v.dtype)
        p_sel = p[..., :n_sel * MOBA_BLOCK].reshape(B, H, MOBA_Q_CHUNK, n_sel, MOBA_BLOCK)
        p_own = p[..., n_sel * MOBA_BLOCK:]
        return (jnp.einsum('bhqrp,bhqrpd->bhqd', p_sel, v_sel)
                + jnp.einsum('bhqp,bhpd->bhqd', p_own, v_own))

    starts = jnp.arange(nc, dtype=jnp.int32) * MOBA_Q_CHUNK
    out = lax.map(chunk_fn, (to_chunks(q), to_chunks(sel_idx), to_chunks(sel_valid), starts))
    return jnp.moveaxis(out, 0, 2).reshape(B, H, S, Dh)


def conformer_conv(a, gate, w, b, g, beta):
    u = a * jax.nn.sigmoid(gate)
    u = lax.conv_general_dilated(u, w[:, None, :], window_strides=(1,),
                                 padding=[(CONV_KERNEL - 1, 0)],
                                 dimension_numbers=('NWC', 'WIO', 'NWC'),
                                 feature_group_count=CONV_WIDTH) + b
    return jax.nn.silu(layer_norm(u, g, beta))


def peer_ffn(x, w_q, sub_keys, u_tab, v_tab):
    B, S, D = x.shape
    q = (x @ w_q).reshape(B, S, PEER_HEADS, 2, PEER_HALF)
    s = jnp.einsum('bshcd,hckd->bshck', q, sub_keys, preferred_element_type=jnp.float32)
    top_s, top_i = lax.top_k(s, PEER_TOPK)
    comb = top_s[..., 0, :, None] + top_s[..., 1, None, :]
    comb = comb.reshape(B, S, PEER_HEADS, PEER_TOPK * PEER_TOPK)
    best_s, best_c = lax.top_k(comb, PEER_TOPK)
    i1 = jnp.take_along_axis(top_i[..., 0, :], best_c // PEER_TOPK, axis=-1)
    i2 = jnp.take_along_axis(top_i[..., 1, :], best_c % PEER_TOPK, axis=-1)
    expert = (i1 * PEER_NKEYS + i2).reshape(B, S, PEER_HEADS * PEER_TOPK)
    gates = jax.nn.softmax(best_s, axis=-1).reshape(B, S, PEER_HEADS * PEER_TOPK).astype(x.dtype)

    nc = S // PEER_TOK_CHUNK

    def to_chunks(a):
        a = a.reshape(B, nc, PEER_TOK_CHUNK, *a.shape[2:])
        return jnp.moveaxis(a, 1, 0)

    def chunk_fn(args):
        x_c, e_c, g_c = args
        u = u_tab[e_c]
        h = jax.nn.gelu(jnp.einsum('bcd,bced->bce', x_c, u), approximate=False)
        return jnp.einsum('bce,bced->bcd', g_c * h, v_tab[e_c])

    y = lax.map(chunk_fn, (to_chunks(x), to_chunks(expert), to_chunks(gates)))
    return jnp.moveaxis(y, 0, 1).reshape(B, S, D)


def setup_inputs(seed: int = 0) -> dict:
    key = jax.random.key(seed)
    ks = jax.random.split(key, 16)
    f32 = jnp.float32
    x = jax.random.normal(ks[0], (BATCH, SEQ, D_MODEL), f32)
    col_scale = jnp.concatenate([
        jnp.ones((2 * ATTN_WIDTH,), f32),
        jnp.full((ATTN_WIDTH,), DEEPNORM_BETA, f32),
        jnp.ones((2 * CONV_WIDTH,), f32)])
    w_in = jax.random.normal(ks[1], (DEPTH, D_MODEL, MIX_IN), f32) * D_MODEL ** -0.5 * col_scale
    conv_w = jax.random.normal(ks[2], (DEPTH, CONV_KERNEL, CONV_WIDTH), f32) * CONV_KERNEL ** -0.5
    conv_b = 0.01 * jax.random.normal(ks[3], (DEPTH, CONV_WIDTH), f32)
    conv_ln_g = 1.0 + 0.01 * jax.random.normal(ks[4], (DEPTH, CONV_WIDTH), f32)
    conv_ln_b = 0.01 * jax.random.normal(ks[5], (DEPTH, CONV_WIDTH), f32)
    w_out = jax.random.normal(ks[6], (DEPTH, D_MODEL, D_MODEL), f32) * D_MODEL ** -0.5 * DEEPNORM_BETA
    ln1_g = 1.0 + 0.01 * jax.random.normal(ks[7], (DEPTH, D_MODEL), f32)
    ln1_b = 0.01 * jax.random.normal(ks[8], (DEPTH, D_MODEL), f32)
    peer_wq = jax.random.normal(ks[9], (DEPTH, D_MODEL, PEER_HEADS * PEER_QDIM), f32) * D_MODEL ** -0.5
    peer_keys = jax.random.normal(ks[10], (DEPTH, PEER_HEADS, 2, PEER_NKEYS, PEER_HALF), f32) * PEER_HALF ** -0.5
    peer_u = jax.random.normal(ks[11], (DEPTH, PEER_EXPERTS, D_MODEL), f32) * D_MODEL ** -0.5
    peer_v = jax.random.normal(ks[12], (DEPTH, PEER_EXPERTS, D_MODEL), f32) * DEEPNORM_BETA
    ln2_g = 1.0 + 0.01 * jax.random.normal(ks[13], (DEPTH, D_MODEL), f32)
    ln2_b = 0.01 * jax.random.normal(ks[14], (DEPTH, D_MODEL), f32)
    return {"x": x, "w_in": w_in, "conv_w": conv_w, "conv_b": conv_b,
            "conv_ln_g": conv_ln_g, "conv_ln_b": conv_ln_b, "w_out": w_out,
            "ln1_g": ln1_g, "ln1_b": ln1_b, "peer_wq": peer_wq, "peer_keys": peer_keys,
            "peer_u": peer_u, "peer_v": peer_v, "ln2_g": ln2_g, "ln2_b": ln2_b}


def reference(x, w_in, conv_w, conv_b, conv_ln_g, conv_ln_b, w_out, ln1_g, ln1_b,
              peer_wq, peer_keys, peer_u, peer_v, ln2_g, ln2_b):
    B, S, _ = x.shape
    cos, sin = rope_tables(S)
    cuts = [ATTN_WIDTH, 2 * ATTN_WIDTH, 3 * ATTN_WIDTH, 3 * ATTN_WIDTH + CONV_WIDTH]
    for l in range(DEPTH):
        proj = x @ w_in[l]
        q, k, v, a, g = jnp.split(proj, cuts, axis=-1)
        q = apply_rope(split_heads(q, B, S), cos, sin)
        k = apply_rope(split_heads(k, B, S), cos, sin)
        attn = moba_attention(q, k, split_heads(v, B, S))
        attn = attn.transpose(0, 2, 1, 3).reshape(B, S, ATTN_WIDTH)
        conv = conformer_conv(a, g, conv_w[l], conv_b[l], conv_ln_g[l], conv_ln_b[l])
        mixed = jnp.concatenate([attn, conv], axis=-1) @ w_out[l]
        x = layer_norm(DEEPNORM_ALPHA * x + mixed, ln1_g[l], ln1_b[l])
        ffn = peer_ffn(x, peer_wq[l], peer_keys[l], peer_u[l], peer_v[l])
        x = layer_norm(DEEPNORM_ALPHA * x + ffn, ln2_g[l], ln2_b[l])
    return x
```

```cpp
#include <hip/hip_runtime.h>
#include <cstdio>
#include <cstdint>
#include <cmath>

namespace {
constexpr int BATCH = 4, SEQ = 4096, DM = 1024, T = BATCH * SEQ, DEPTH = 2;
constexpr int NH = 8, HD = 64, AW = 512, CWID = 512, CK = 31, MIXIN = 2560;
constexpr int NBLK = 16, MBLK = 256;
constexpr int PH = 8, NKEYS = 128, PHALF = 128, PTOPK = 16, NEXP = 16384, PQ = 2048;
constexpr float LN_EPS = 1e-5f;
constexpr float ALPHA = 1.41421356237309515f;

__global__ void __launch_bounds__(256) sgemm_k(const float* __restrict__ A, const float* __restrict__ B, float* __restrict__ C, int M, int N, int K) {
    __shared__ float As[16][68];
    __shared__ float Bs[16][68];
    const int tx = threadIdx.x & 15, ty = threadIdx.x >> 4;
    const int m0 = blockIdx.y * 64, n0 = blockIdx.x * 64;
    float acc[4][4];
#pragma unroll
    for (int i = 0; i < 4; ++i)
#pragma unroll
        for (int j = 0; j < 4; ++j) acc[i][j] = 0.f;
    for (int k0 = 0; k0 < K; k0 += 16) {
#pragma unroll
        for (int r = 0; r < 4; ++r) { const int i = threadIdx.x + r * 256; const int m = i >> 4, k = i & 15; As[k][m] = A[(size_t)(m0 + m) * K + k0 + k]; }
#pragma unroll
        for (int r = 0; r < 4; ++r) { const int i = threadIdx.x + r * 256; const int k = i >> 6, n = i & 63; Bs[k][n] = B[(size_t)(k0 + k) * N + n0 + n]; }
        __syncthreads();
#pragma unroll
        for (int k = 0; k < 16; ++k) {
            float a[4], b[4];
#pragma unroll
            for (int i = 0; i < 4; ++i) { a[i] = As[k][ty * 4 + i]; b[i] = Bs[k][tx * 4 + i]; }
#pragma unroll
            for (int i = 0; i < 4; ++i)
#pragma unroll
                for (int j = 0; j < 4; ++j) acc[i][j] += a[i] * b[j];
        }
        __syncthreads();
    }
#pragma unroll
    for (int i = 0; i < 4; ++i)
#pragma unroll
        for (int j = 0; j < 4; ++j) C[(size_t)(m0 + ty * 4 + i) * N + n0 + tx * 4 + j] = acc[i][j];
}

__global__ void rope_k(float* __restrict__ proj) {
    const size_t gid = (size_t)blockIdx.x * blockDim.x + threadIdx.x;
    if (gid >= (size_t)T * 2 * NH * 32) return;
    const int i = gid & 31; const int h = (gid >> 5) & 7; const int which = (gid >> 8) & 1; const size_t t = gid >> 9;
    const int pos = (int)(t % SEQ);
    const float inv = powf(10000.0f, -(float)i / 32.0f);
    const float ang = (float)pos * inv;
    const float c = cosf(ang), s = sinf(ang);
    float* p = proj + t * MIXIN + which * AW + h * HD + i;
    const float t1 = p[0], t2 = p[32];
    p[0] = t1 * c - t2 * s; p[32] = t2 * c + t1 * s;
}

__global__ void kmean_k(const float* __restrict__ proj, float* __restrict__ kmean) {
    const int gid = blockIdx.x * blockDim.x + threadIdx.x;
    if (gid >= BATCH * NH * NBLK * HD) return;
    const int d = gid & 63, n = (gid >> 6) & 15, h = (gid >> 10) & 7, b = gid >> 13;
    const float* p = proj + ((size_t)b * SEQ + (size_t)n * MBLK) * MIXIN + AW + h * HD + d;
    float s = 0.f;
    for (int j = 0; j < MBLK; ++j) s += p[(size_t)j * MIXIN];
    kmean[gid] = s * (1.0f / MBLK);
}

__device__ __forceinline__ float wave_max(float v) {
#pragma unroll
    for (int o = 1; o < 64; o <<= 1) v = fmaxf(v, __shfl_xor(v, o));
    return v;
}
__device__ __forceinline__ float wave_sum(float v) {
#pragma unroll
    for (int o = 1; o < 64; o <<= 1) v += __shfl_xor(v, o);
    return v;
}

__global__ void __launch_bounds__(256) moba_k(const float* __restrict__ proj, const float* __restrict__ kmean, float* __restrict__ mix) {
    __shared__ float pbuf[4][1024];
    __shared__ float gbuf[4][16];
    const int w = threadIdx.x >> 6, lane = threadIdx.x & 63;
    const int gw = blockIdx.x * 4 + w;
    const int s = gw % SEQ, h = (gw / SEQ) % NH, b = gw / (SEQ * NH);
    const int qb = s / MBLK;
    const float* qp = proj + ((size_t)b * SEQ + s) * MIXIN + h * HD;
    float q[64];
#pragma unroll
    for (int i = 0; i < 16; ++i) { const float4 v = ((const float4*)qp)[i]; q[4 * i] = v.x; q[4 * i + 1] = v.y; q[4 * i + 2] = v.z; q[4 * i + 3] = v.w; }
    if (lane < 16) {
        float g = -INFINITY;
        if (lane < qb) { const float* km = kmean + (((size_t)b * NH + h) * NBLK + lane) * HD; g = 0.f;
#pragma unroll
            for (int d = 0; d < 64; ++d) g += q[d] * km[d]; }
        gbuf[w][lane] = g;
    }
    __syncthreads();
    float gs[16];
#pragma unroll
    for (int n = 0; n < 16; ++n) gs[n] = gbuf[w][n];
    int blks[4]; bool val[4];
#pragma unroll
    for (int r = 0; r < 3; ++r) {
        float best = -INFINITY; int bi = -1;
#pragma unroll
        for (int n = 0; n < 16; ++n) if (gs[n] > best) { best = gs[n]; bi = n; }
        val[r] = (bi >= 0); blks[r] = bi >= 0 ? bi : 0;
#pragma unroll
        for (int n = 0; n < 16; ++n) if (n == bi) gs[n] = -INFINITY;
    }
    blks[3] = qb; val[3] = true;
    float sc[4][4]; float mx = -INFINITY;
#pragma unroll
    for (int r = 0; r < 4; ++r) {
#pragma unroll
        for (int i = 0; i < 4; ++i) {
            const int j = lane + 64 * i; const int p = blks[r] * MBLK + j;
            float v = -INFINITY;
            if (val[r] && (r < 3 || p <= s)) {
                const float* kp = proj + ((size_t)b * SEQ + p) * MIXIN + AW + h * HD; float a = 0.f;
#pragma unroll
                for (int d4 = 0; d4 < 16; ++d4) { const float4 kv = ((const float4*)kp)[d4]; a += q[4 * d4] * kv.x + q[4 * d4 + 1] * kv.y + q[4 * d4 + 2] * kv.z + q[4 * d4 + 3] * kv.w; }
                v = a * 0.125f;
            }
            sc[r][i] = v; mx = fmaxf(mx, v);
        }
    }
    mx = wave_max(mx);
    float sum = 0.f;
#pragma unroll
    for (int r = 0; r < 4; ++r)
#pragma unroll
        for (int i = 0; i < 4; ++i) { const float e = (sc[r][i] == -INFINITY) ? 0.f : expf(sc[r][i] - mx); sc[r][i] = e; sum += e; }
    sum = wave_sum(sum);
    const float rs = 1.0f / sum;
#pragma unroll
    for (int r = 0; r < 4; ++r)
#pragma unroll
        for (int i = 0; i < 4; ++i) pbuf[w][r * 256 + lane + 64 * i] = sc[r][i] * rs;
    __syncthreads();
    float o = 0.f;
#pragma unroll
    for (int r = 0; r < 4; ++r) {
        if (!val[r]) continue;
        const float* vp = proj + ((size_t)b * SEQ + (size_t)blks[r] * MBLK) * MIXIN + 2 * AW + h * HD + lane;
        const int lim = (r == 3) ? (s - qb * MBLK + 1) : MBLK;
        for (int j = 0; j < lim; ++j) o += pbuf[w][r * 256 + j] * vp[(size_t)j * MIXIN];
    }
    mix[((size_t)b * SEQ + s) * DM + h * HD + lane] = o;
}

__global__ void __launch_bounds__(256) conv_k(const float* __restrict__ proj, const float* __restrict__ cw, const float* __restrict__ cb,
                                              const float* __restrict__ cg, const float* __restrict__ cbeta, float* __restrict__ mix) {
    __shared__ float red[8];
    const int t = blockIdx.x, s = t % SEQ, tid = threadIdx.x;
    float u[2];
#pragma unroll
    for (int e = 0; e < 2; ++e) {
        const int c = tid + 256 * e; float acc = 0.f;
        for (int j = 0; j < CK; ++j) {
            const int ss = s - (CK - 1) + j; if (ss < 0) continue;
            const float* pr = proj + (size_t)(t - (CK - 1) + j) * MIXIN;
            const float a = pr[3 * AW + c], g = pr[3 * AW + CWID + c];
            acc += cw[j * CWID + c] * (a / (1.0f + expf(-g)));
        }
        u[e] = acc + cb[c];
    }
    float sm = wave_sum(u[0] + u[1]);
    if ((tid & 63) == 0) red[tid >> 6] = sm;
    __syncthreads();
    const float mean = (red[0] + red[1] + red[2] + red[3]) * (1.0f / CWID);
    const float d0 = u[0] - mean, d1 = u[1] - mean;
    float sq = wave_sum(d0 * d0 + d1 * d1);
    if ((tid & 63) == 0) red[4 + (tid >> 6)] = sq;
    __syncthreads();
    const float var = (red[4] + red[5] + red[6] + red[7]) * (1.0f / CWID);
    const float rstd = 1.0f / sqrtf(var + LN_EPS);
#pragma unroll
    for (int e = 0; e < 2; ++e) {
        const int c = tid + 256 * e;
        const float y = (u[e] - mean) * rstd * cg[c] + cbeta[c];
        mix[(size_t)t * DM + AW + c] = y / (1.0f + expf(-y));
    }
}

__global__ void __launch_bounds__(256) ln_k(const float* __restrict__ x, const float* __restrict__ m, const float* __restrict__ g, const float* __restrict__ bta, float* __restrict__ out) {
    __shared__ float red[8];
    const int t = blockIdx.x, tid = threadIdx.x;
    const float4 xv = ((const float4*)(x + (size_t)t * DM))[tid], mv = ((const float4*)(m + (size_t)t * DM))[tid];
    float v[4] = {ALPHA * xv.x + mv.x, ALPHA * xv.y + mv.y, ALPHA * xv.z + mv.z, ALPHA * xv.w + mv.w};
    float sm = wave_sum((v[0] + v[1]) + (v[2] + v[3]));
    if ((tid & 63) == 0) red[tid >> 6] = sm;
    __syncthreads();
    const float mean = (red[0] + red[1] + red[2] + red[3]) * (1.0f / DM);
    float sq = 0.f;
#pragma unroll
    for (int i = 0; i < 4; ++i) { v[i] -= mean; sq += v[i] * v[i]; }
    sq = wave_sum(sq);
    if ((tid & 63) == 0) red[4 + (tid >> 6)] = sq;
    __syncthreads();
    const float rstd = 1.0f / sqrtf((red[4] + red[5] + red[6] + red[7]) * (1.0f / DM) + LN_EPS);
    const float4 gv = ((const float4*)g)[tid], bv = ((const float4*)bta)[tid];
    float4 o; o.x = v[0] * rstd * gv.x + bv.x; o.y = v[1] * rstd * gv.y + bv.y; o.z = v[2] * rstd * gv.z + bv.z; o.w = v[3] * rstd * gv.w + bv.w;
    ((float4*)(out + (size_t)t * DM))[tid] = o;
}

__global__ void __launch_bounds__(256) peer_route_k(const float* __restrict__ qp, const float* __restrict__ keys, int* __restrict__ eidx, float* __restrict__ egate) {
    __shared__ float qs[PQ];
    __shared__ float sc[16][NKEYS];
    __shared__ float part[256];
    __shared__ float tops[16][PTOPK];
    __shared__ int topi[16][PTOPK];
    const int t = blockIdx.x, tid = threadIdx.x, w = tid >> 6, lane = tid & 63;
    for (int i = tid; i < PQ; i += 256) qs[i] = qp[(size_t)t * PQ + i];
    __syncthreads();
    for (int hc = 0; hc < 16; ++hc) {
        const int k = tid & 127, half = tid >> 7;
        const float* kp = keys + ((size_t)hc * NKEYS + k) * PHALF + half * 64;
        const float* qq = qs + hc * PHALF + half * 64;
        float a = 0.f;
#pragma unroll 16
        for (int d = 0; d < 64; ++d) a += qq[d] * kp[d];
        part[tid] = a;
        __syncthreads();
        if (tid < 128) sc[hc][tid] = part[tid] + part[tid + 128];
        __syncthreads();
    }
    for (int rr = 0; rr < 4; ++rr) {
        const int row = w * 4 + rr;
        float v0 = sc[row][lane], v1 = sc[row][lane + 64];
        for (int r = 0; r < PTOPK; ++r) {
            float bv; int bi;
            if (v0 >= v1) { bv = v0; bi = lane; } else { bv = v1; bi = lane + 64; }
#pragma unroll
            for (int o = 1; o < 64; o <<= 1) { const float ov = __shfl_xor(bv, o); const int oi = __shfl_xor(bi, o); if (ov > bv || (ov == bv && oi < bi)) { bv = ov; bi = oi; } }
            if (lane == 0) { tops[row][r] = bv; topi[row][r] = bi; }
            if (bi == lane) v0 = -INFINITY; if (bi == lane + 64) v1 = -INFINITY;
        }
    }
    __syncthreads();
    for (int hh = 0; hh < 2; ++hh) {
        const int h = w * 2 + hh;
        float v[4];
#pragma unroll
        for (int m = 0; m < 4; ++m) { const int idx = lane + 64 * m; v[m] = tops[2 * h][idx >> 4] + tops[2 * h + 1][idx & 15]; }
        float bs[PTOPK]; int bc[PTOPK];
#pragma unroll
        for (int r = 0; r < PTOPK; ++r) {
            float bv = v[0]; int bi = lane;
#pragma unroll
            for (int m = 1; m < 4; ++m) if (v[m] > bv) { bv = v[m]; bi = lane + 64 * m; }
#pragma unroll
            for (int o = 1; o < 64; o <<= 1) { const float ov = __shfl_xor(bv, o); const int oi = __shfl_xor(bi, o); if (ov > bv || (ov == bv && oi < bi)) { bv = ov; bi = oi; } }
            bs[r] = bv; bc[r] = bi;
#pragma unroll
            for (int m = 0; m < 4; ++m) if (bi == lane + 64 * m) v[m] = -INFINITY;
        }
        float e[PTOPK], sum = 0.f;
#pragma unroll
        for (int r = 0; r < PTOPK; ++r) { e[r] = expf(bs[r] - bs[0]); sum += e[r]; }
        const float rs = 1.0f / sum;
#pragma unroll
        for (int r = 0; r < PTOPK; ++r) if (lane == r) {
            const int i1 = topi[2 * h][bc[r] >> 4], i2 = topi[2 * h + 1][bc[r] & 15];
            eidx[(size_t)t * 128 + h * 16 + r] = i1 * NKEYS + i2;
            egate[(size_t)t * 128 + h * 16 + r] = e[r] * rs;
        }
    }
}

__global__ void __launch_bounds__(256) peer_expert_k(const float* __restrict__ x, const float* __restrict__ ut, const float* __restrict__ vt,
                                                     const int* __restrict__ eidx, const float* __restrict__ egate, float* __restrict__ y) {
    __shared__ float ys[4][DM];
    const int t = blockIdx.x, tid = threadIdx.x, w = tid >> 6, lane = tid & 63;
    float4 xr[4], acc[4];
#pragma unroll
    for (int j = 0; j < 4; ++j) { xr[j] = ((const float4*)(x + (size_t)t * DM))[j * 64 + lane]; acc[j] = make_float4(0.f, 0.f, 0.f, 0.f); }
    for (int i = w; i < 128; i += 4) {
        const int e = eidx[(size_t)t * 128 + i]; const float g = egate[(size_t)t * 128 + i];
        const float4* up = (const float4*)(ut + (size_t)e * DM); const float4* vp = (const float4*)(vt + (size_t)e * DM);
        float d = 0.f;
#pragma unroll
        for (int j = 0; j < 4; ++j) { const float4 uv = up[j * 64 + lane]; d += xr[j].x * uv.x + xr[j].y * uv.y + xr[j].z * uv.z + xr[j].w * uv.w; }
        d = wave_sum(d);
        const float hh = 0.5f * d * (1.0f + erff(d * 0.70710678118654752f));
        const float c = g * hh;
#pragma unroll
        for (int j = 0; j < 4; ++j) { const float4 vv = vp[j * 64 + lane]; acc[j].x += c * vv.x; acc[j].y += c * vv.y; acc[j].z += c * vv.z; acc[j].w += c * vv.w; }
    }
#pragma unroll
    for (int j = 0; j < 4; ++j) ((float4*)ys[w])[j * 64 + lane] = acc[j];
    __syncthreads();
    const float4 a = ((const float4*)ys[0])[tid], b = ((const float4*)ys[1])[tid], c = ((const float4*)ys[2])[tid], d = ((const float4*)ys[3])[tid];
    float4 o; o.x = (a.x + b.x) + (c.x + d.x); o.y = (a.y + b.y) + (c.y + d.y); o.z = (a.z + b.z) + (c.z + d.z); o.w = (a.w + b.w) + (c.w + d.w);
    ((float4*)(y + (size_t)t * DM))[tid] = o;
}
}

extern "C" void kernel_launch(void* const* d_in, const int* in_sizes, int n_in, void* d_out, int out_size, void* d_ws, size_t ws_size, hipStream_t stream) {
    const float* x0 = (const float*)d_in[0]; const float* w_in = (const float*)d_in[1]; const float* conv_w = (const float*)d_in[2]; const float* conv_b = (const float*)d_in[3];
    const float* conv_g = (const float*)d_in[4]; const float* conv_beta = (const float*)d_in[5]; const float* w_out = (const float*)d_in[6]; const float* ln1_g = (const float*)d_in[7];
    const float* ln1_b = (const float*)d_in[8]; const float* wq = (const float*)d_in[9]; const float* pkeys = (const float*)d_in[10]; const float* pu = (const float*)d_in[11];
    const float* pv = (const float*)d_in[12]; const float* ln2_g = (const float*)d_in[13]; const float* ln2_b = (const float*)d_in[14];
    char* ws = (char*)d_ws; const size_t MiB = 1u << 20;
    float* proj = (float*)(ws);
    float* mix = (float*)(ws + 160 * MiB);
    float* mixed = (float*)(ws + 224 * MiB);
    float* x1 = (float*)(ws + 288 * MiB);
    float* x2 = (float*)(ws + 352 * MiB);
    int* eidx = (int*)(ws + 416 * MiB);
    float* egate = (float*)(ws + 424 * MiB);
    float* kmean = (float*)(ws + 432 * MiB);
    if (ws_size < 440 * MiB) { fprintf(stderr, "workspace too small\n"); return; }
    const float* xin = x0;
    for (int l = 0; l < DEPTH; ++l) {
        float* xout = (l == DEPTH - 1) ? (float*)d_out : x2;
        hipLaunchKernelGGL(sgemm_k, dim3(MIXIN / 64, T / 64), dim3(256), 0, stream, xin, w_in + (size_t)l * DM * MIXIN, proj, T, MIXIN, DM);
        hipLaunchKernelGGL(rope_k, dim3((T * 2 * NH * 32) / 256), dim3(256), 0, stream, proj);
        hipLaunchKernelGGL(kmean_k, dim3(BATCH * NH * NBLK * HD / 256), dim3(256), 0, stream, proj, kmean);
        hipLaunchKernelGGL(moba_k, dim3(BATCH * NH * SEQ / 4), dim3(256), 0, stream, proj, kmean, mix);
        hipLaunchKernelGGL(conv_k, dim3(T), dim3(256), 0, stream, proj, conv_w + (size_t)l * CK * CWID, conv_b + l * CWID, conv_g + l * CWID, conv_beta + l * CWID, mix);
        hipLaunchKernelGGL(sgemm_k, dim3(DM / 64, T / 64), dim3(256), 0, stream, mix, w_out + (size_t)l * DM * DM, mixed, T, DM, DM);
        hipLaunchKernelGGL(ln_k, dim3(T), dim3(256), 0, stream, xin, mixed, ln1_g + l * DM, ln1_b + l * DM, x1);
        hipLaunchKernelGGL(sgemm_k, dim3(PQ / 64, T / 64), dim3(256), 0, stream, x1, wq + (size_t)l * DM * PQ, proj, T, PQ, DM);
        hipLaunchKernelGGL(peer_route_k, dim3(T), dim3(256), 0, stream, proj, pkeys + (size_t)l * PH * 2 * NKEYS * PHALF, eidx, egate);
        hipLaunchKernelGGL(peer_expert_k, dim3(T), dim3(256), 0, stream, x1, pu + (size_t)l * NEXP * DM, pv + (size_t)l * NEXP * DM, eidx, egate, mixed);
        hipLaunchKernelGGL(ln_k, dim3(T), dim3(256), 0, stream, x1, mixed, ln2_g + l * DM, ln2_b + l * DM, xout);
        xin = xout;
    }
}
```
